# Optimizing an MI355X kernel written in HIP

```python
import math
import jax, jax.numpy as jnp
from jax import lax
import numpy as np

D_MODEL = 1024
BATCH = 4
SEQ = 4096
DEPTH = 2
DEC_BATCH = 16
DEC_SEQ = 64
PAST_LEN = 2048

CHUNK = 64
N_EVEN = (DEPTH + 1) // 2
N_ODD = DEPTH // 2
FF_DIM = 2816
EPS = 1e-6
CONV_W = 4
RET_HEADS = 4
RET_DK = 128
RET_DV = 128
ROPE_BASE = 10000.0
HG_HEADS = 4
HG_DK = 128
HG_DV = 128
LRU_WIDTH = 512
LRU_BLOCKS = 8
LRU_BS = LRU_WIDTH // LRU_BLOCKS
LRU_C = 8.0
DN_HEADS = 4
DN_DK = 128
DN_DV = 128
DN_CONV_CH = 2 * DN_HEADS * DN_DK + DN_HEADS * DN_DV

EVEN_SPLITS = [RET_HEADS * RET_DK, RET_HEADS * RET_DK, RET_HEADS * RET_DV, RET_HEADS * RET_DV,
               HG_HEADS * HG_DK, HG_HEADS * HG_DK, HG_HEADS * HG_DV, HG_HEADS * HG_DV]
EVEN_IN = sum(EVEN_SPLITS)
EVEN_MIX = RET_HEADS * RET_DV + HG_HEADS * HG_DV
ODD_SPLITS = [LRU_WIDTH, LRU_WIDTH, DN_HEADS * DN_DK, DN_HEADS * DN_DK, DN_HEADS * DN_DV,
              DN_HEADS * DN_DV, DN_HEADS, DN_HEADS]
ODD_IN = sum(ODD_SPLITS)
ODD_MIX = LRU_WIDTH + DN_HEADS * DN_DV

kernel_name = 'chunk_causal_hybrid_retention_hgrn2_rglru_gdn_step'


def split_cols(z, sizes):
    idx = np.cumsum(sizes)[:-1].tolist()
    return jnp.split(z, idx, axis=-1)


def rmsnorm(x, g):
    xf = x.astype(jnp.float32)
    y = xf * lax.rsqrt(jnp.mean(xf * xf, axis=-1, keepdims=True) + EPS)
    return (y * g).astype(x.dtype)


def head_rmsnorm(o, g):
    B, T, H, d = o.shape
    o = o * lax.rsqrt(jnp.mean(o * o, axis=-1, keepdims=True) + EPS)
    return o.reshape(B, T, H * d) * g.astype(o.dtype)


def l2norm(x):
    return x * lax.rsqrt(jnp.sum(x * x, axis=-1, keepdims=True) + EPS)


def swiglu(x, w_in, w_out):
    gate, up = jnp.split(x @ w_in, 2, axis=-1)
    return (jax.nn.silu(gate) * up) @ w_out


def rope(x, pos):
    half = x.shape[-1] // 2
    freq = ROPE_BASE ** (-jnp.arange(half, dtype=jnp.float32) / half)
    ang = pos.astype(jnp.float32)[:, None] * freq[None, :]
    cos = jnp.cos(ang)[None, :, None, :]
    sin = jnp.sin(ang)[None, :, None, :]
    x1, x2 = x[..., :half], x[..., half:]
    return jnp.concatenate([x1 * cos - x2 * sin, x1 * sin + x2 * cos], axis=-1)


def to_chunks(x, c):
    B, T, H = x.shape[:3]
    rest = x.shape[3:]
    x = x.reshape((B, T // c, c, H) + rest)
    perm = (1, 0, 3, 2) + tuple(range(4, x.ndim))
    return x.transpose(perm)


def from_chunks(o):
    N, B, H, C, d = o.shape
    return o.transpose(1, 0, 3, 2, 4).reshape(B, N * C, H, d)


def causal_conv(x, buf, w):
    T = x.shape[1]
    xp = jnp.concatenate([buf.astype(x.dtype), x], axis=1)
    y = sum(xp[:, j:j + T] * w[j] for j in range(CONV_W))
    return y, xp[:, -(CONV_W - 1):]


def retention(q, k, v, s0, c):
    ar = jnp.arange(RET_HEADS, dtype=jnp.float32)
    log_g = jnp.log1p(-jnp.exp2(-5.0 - ar))
    p = jnp.arange(c, dtype=jnp.float32)
    intra = jnp.exp(log_g[:, None, None] * jnp.abs(p[:, None] - p[None, :]))
    q_dec = jnp.exp(log_g[:, None] * (p + 1.0))[..., None]
    k_dec = jnp.exp(log_g[:, None] * (c - 1.0 - p))[..., None]
    s_dec = jnp.exp(log_g * c)[:, None, None]

    def step(s, inp):
        qc, kc, vc = inp
        att = jnp.einsum('bhtd,bhsd->bhts', qc, kc) * intra
        o = (jnp.einsum('bhts,bhse->bhte', att, vc)
             + jnp.einsum('bhtd,bhde->bhte', qc * q_dec, s))
        s = s * s_dec + jnp.einsum('bhsd,bhse->bhde', kc * k_dec, vc)
        return s, o

    s, o = lax.scan(step, s0, (to_chunks(q, c), to_chunks(k, c), to_chunks(v, c)))
    return from_chunks(o), s


def hgrn2_chunked(q, k, v, logf, s0, c):
    incl = jnp.tril(jnp.ones((c, c), bool))[:, :, None]

    def step(s, inp):
        qc, kc, vc, gc = inp
        b = jnp.cumsum(gc, axis=2)
        rel = b[:, :, :, None, :] - b[:, :, None, :, :]
        dec = jnp.exp(jnp.where(incl, rel, -jnp.inf))
        att = jnp.einsum('bhtd,bhsd,bhtsd->bhts', qc, kc, dec)
        o = (jnp.einsum('bhts,bhse->bhte', att, vc)
             + jnp.einsum('bhtd,bhde->bhte', qc * jnp.exp(b), s))
        b_end = b[:, :, -1:, :]
        s = (s * jnp.exp(b_end)[:, :, 0, :, None]
             + jnp.einsum('bhsd,bhse->bhde', kc * jnp.exp(b_end - b), vc))
        return s, o

    xs = (to_chunks(q, c), to_chunks(k, c), to_chunks(v, c), to_chunks(logf, c))
    s, o = lax.scan(step, s0, xs)
    return from_chunks(o), s


def gated_delta_chunked(q, k, v, beta, loga, s0, c):
    strict = jnp.tril(jnp.ones((c, c), bool), -1)
    incl = jnp.tril(jnp.ones((c, c), bool))
    eye = jnp.eye(c, dtype=jnp.float32)

    def step(s, inp):
        qc, kc, vc, bc, gc = inp
        g = jnp.cumsum(gc, axis=-1)
        rel = g[..., :, None] - g[..., None, :]
        a_mat = (bc[..., None] * jnp.einsum('bhtd,bhsd->bhts', kc, kc)
                 * jnp.exp(jnp.where(strict, rel, -jnp.inf)))
        eg = jnp.exp(g)[..., None]
        rhs = bc[..., None] * (vc - eg * jnp.einsum('bhtd,bhde->bhte', kc, s))
        w = lax.linalg.triangular_solve(eye + a_mat, rhs, left_side=True, lower=True,
                                        unit_diagonal=True)
        qk = jnp.einsum('bhtd,bhsd->bhts', qc, kc) * jnp.exp(jnp.where(incl, rel, -jnp.inf))
        o = eg * jnp.einsum('bhtd,bhde->bhte', qc, s) + jnp.einsum('bhts,bhse->bhte', qk, w)
        g_end = g[..., -1:]
        s = (s * jnp.exp(g_end)[..., None]
             + jnp.einsum('bhsd,bhse->bhde', kc * jnp.exp(g_end - g)[..., None], w))
        return s, o

    xs = (to_chunks(q, c), to_chunks(k, c), to_chunks(v, c), to_chunks(beta, c), to_chunks(loga, c))
    s, o = lax.scan(step, s0, xs)
    return from_chunks(o), s


def rg_lru(x, h0, w_a, b_a, w_x, b_x, lam):
    B, T, W = x.shape
    xb = x.reshape(B, T, LRU_BLOCKS, LRU_BS)
    r = jax.nn.sigmoid(jnp.einsum('btnd,nde->btne', xb, w_a).reshape(B, T, W) + b_a)
    i = jax.nn.sigmoid(jnp.einsum('btnd,nde->btne', xb, w_x).reshape(B, T, W) + b_x)
    log_a = -LRU_C * r * jax.nn.softplus(-lam)
    a = jnp.exp(log_a)
    u = jnp.sqrt(-jnp.expm1(2.0 * log_a)) * (i * x)

    def combine(l, rr):
        return (l[0] * rr[0], rr[0] * l[1] + rr[1])

    a_cum, h_part = lax.associative_scan(combine, (a, u), axis=1)
    h = a_cum * h0[:, None, :] + h_part
    return h, h[:, -1]


def even_mixer(h, pos, c, ret_s, hg_s, lb, p, j):
    B, T, _ = h.shape
    f32 = jnp.float32
    z = (h @ p['even_w_in'][j]).astype(f32)
    rq, rk, rv, rg, hq, hf, hi, hog = split_cols(z, EVEN_SPLITS)

    def heads(t, n):
        return t.reshape(B, T, n, -1)

    rq = rope(heads(rq, RET_HEADS), pos) * (RET_DK ** -0.5)
    rk = rope(heads(rk, RET_HEADS), pos)
    ret_o, ret_new = retention(rq, rk, heads(rv, RET_HEADS), ret_s.astype(f32), c)
    ret_o = head_rmsnorm(ret_o, p['ret_out_norm'][j]) * jax.nn.silu(rg)
    logf = jnp.logaddexp(jnp.log(lb), jnp.log1p(-lb) + jax.nn.log_sigmoid(hf))
    hk = (1.0 - lb) * jax.nn.sigmoid(-hf)
    hg_o, hg_new = hgrn2_chunked(heads(jax.nn.silu(hq), HG_HEADS), heads(hk, HG_HEADS),
                                 heads(hi, HG_HEADS), heads(logf, HG_HEADS), hg_s.astype(f32), c)
    hg_o = head_rmsnorm(hg_o, p['hg_out_norm'][j]) * jax.nn.silu(hog)
    out = jnp.concatenate([ret_o, hg_o], axis=-1).astype(h.dtype) @ p['even_w_out'][j]
    return out, ret_new, hg_new


def odd_mixer(h, c, lru_h, lru_conv, dn_s, dn_conv, p, j):
    B, T, _ = h.shape
    f32 = jnp.float32
    z = (h @ p['odd_w_in'][j]).astype(f32)
    lx, lg, dq, dk, dv, dog, db, da = split_cols(z, ODD_SPLITS)
    lx, lru_conv_new = causal_conv(lx, lru_conv.astype(f32), p['lru_conv_w'][j])
    lx = lx + p['lru_conv_b'][j]
    hseq, lru_h_new = rg_lru(lx, lru_h.astype(f32), p['lru_w_a'][j], p['lru_b_a'][j],
                             p['lru_w_x'][j], p['lru_b_x'][j], p['lru_lambda'][j])
    lru_o = jax.nn.gelu(lg) * hseq
    qkv, dn_conv_new = causal_conv(jnp.concatenate([dq, dk, dv], axis=-1), dn_conv.astype(f32),
                                   p['dn_conv_w'][j])
    qkv = jax.nn.silu(qkv)
    q, k, v = split_cols(qkv, [DN_HEADS * DN_DK, DN_HEADS * DN_DK, DN_HEADS * DN_DV])
    q = l2norm(q.reshape(B, T, DN_HEADS, DN_DK)) * (DN_DK ** -0.5)
    k = l2norm(k.reshape(B, T, DN_HEADS, DN_DK))
    v = v.reshape(B, T, DN_HEADS, DN_DV)
    beta = jax.nn.sigmoid(db)
    loga = -jnp.exp(p['dn_a_log'][j]) * jax.nn.softplus(da + p['dn_dt_bias'][j])
    dn_o, dn_new = gated_delta_chunked(q, k, v, beta, loga, dn_s.astype(f32), c)
    dn_o = head_rmsnorm(dn_o, p['dn_out_norm'][j]) * jax.nn.silu(dog)
    out = jnp.concatenate([lru_o, dn_o], axis=-1).astype(h.dtype) @ p['odd_w_out'][j]
    return out, lru_h_new, lru_conv_new, dn_new, dn_conv_new


def trunk(x, pos, ret_s, hg_s, lru_h, lru_conv, dn_s, dn_conv, p):
    c = min(CHUNK, x.shape[1])
    lb_all = jnp.cumsum(jax.nn.softmax(p['hg_lb_logits'].astype(jnp.float32), axis=0), axis=0)
    n_ret, n_hg, n_lh, n_lc, n_dn, n_dc = [], [], [], [], [], []
    for l in range(DEPTH):
        j = l // 2
        x = x + 0.5 * swiglu(rmsnorm(x, p['ffn1_norm'][l]), p['ffn1_w_in'][l], p['ffn1_w_out'][l])
        hn = rmsnorm(x, p['mix_norm'][l])
        if l % 2 == 0:
            mix, rs, hs = even_mixer(hn, pos, c, ret_s[j], hg_s[j], lb_all[j], p, j)
            n_ret.append(rs)
            n_hg.append(hs)
        else:
            mix, lh, lc, ds, dc = odd_mixer(hn, c, lru_h[j], lru_conv[j], dn_s[j], dn_conv[j], p, j)
            n_lh.append(lh)
            n_lc.append(lc)
            n_dn.append(ds)
            n_dc.append(dc)
        x = x + mix
        x = x + 0.5 * swiglu(rmsnorm(x, p['ffn2_norm'][l]), p['ffn2_w_in'][l], p['ffn2_w_out'][l])
    y = rmsnorm(x, p['final_norm'])
    return (y, jnp.stack(n_ret), jnp.stack(n_hg), jnp.stack(n_lh), jnp.stack(n_lc),
            jnp.stack(n_dn), jnp.stack(n_dc))


def setup_inputs(seed: int = 0) -> dict:
    key = jax.random.key(seed)
    keys = iter(jax.random.split(key, 40))
    f32 = jnp.float32

    def nrm(shape, scale):
        return jax.random.normal(next(keys), shape, f32) * scale

    def unif(shape, lo, hi):
        return jax.random.uniform(next(keys), shape, f32, lo, hi)

    dsc = D_MODEL ** -0.5
    a8 = unif((N_ODD, LRU_WIDTH), 0.9, 0.999)
    a = a8 ** (1.0 / LRU_C)
    dt = jnp.exp(unif((N_ODD, DN_HEADS), math.log(1e-3), math.log(1e-1)))
    a_heads = unif((N_ODD, DN_HEADS), 1.0, 16.0)
    return {
        'x_prompt': nrm((BATCH, SEQ, D_MODEL), 1.0),
        'x_sample': nrm((DEC_BATCH, DEC_SEQ, D_MODEL), 1.0),
        'state_ret': nrm((N_EVEN, DEC_BATCH, RET_HEADS, RET_DK, RET_DV), 2.0),
        'state_hgrn': nrm((N_EVEN, DEC_BATCH, HG_HEADS, HG_DK, HG_DV), 1.0),
        'state_lru_h': nrm((N_ODD, DEC_BATCH, LRU_WIDTH), 0.5),
        'state_lru_conv': nrm((N_ODD, DEC_BATCH, CONV_W - 1, LRU_WIDTH), 1.0),
        'state_dn': nrm((N_ODD, DEC_BATCH, DN_HEADS, DN_DK, DN_DV), 0.3),
        'state_dn_conv': nrm((N_ODD, DEC_BATCH, CONV_W - 1, DN_CONV_CH), 1.0),
        'ffn1_norm': 1.0 + nrm((DEPTH, D_MODEL), 0.02),
        'ffn1_w_in': nrm((DEPTH, D_MODEL, 2 * FF_DIM), dsc),
        'ffn1_w_out': nrm((DEPTH, FF_DIM, D_MODEL), FF_DIM ** -0.5),
        'mix_norm': 1.0 + nrm((DEPTH, D_MODEL), 0.02),
        'ffn2_norm': 1.0 + nrm((DEPTH, D_MODEL), 0.02),
        'ffn2_w_in': nrm((DEPTH, D_MODEL, 2 * FF_DIM), dsc),
        'ffn2_w_out': nrm((DEPTH, FF_DIM, D_MODEL), FF_DIM ** -0.5),
        'final_norm': 1.0 + nrm((D_MODEL,), 0.02),
        'even_w_in': nrm((N_EVEN, D_MODEL, EVEN_IN), dsc),
        'even_w_out': nrm((N_EVEN, EVEN_MIX, D_MODEL), EVEN_MIX ** -0.5),
        'ret_out_norm': 1.0 + nrm((N_EVEN, RET_HEADS * RET_DV), 0.02),
        'hg_out_norm': 1.0 + nrm((N_EVEN, HG_HEADS * HG_DV), 0.02),
        'hg_lb_logits': nrm((N_EVEN + 1, HG_HEADS * HG_DK), 0.5),
        'odd_w_in': nrm((N_ODD, D_MODEL, ODD_IN), dsc),
        'odd_w_out': nrm((N_ODD, ODD_MIX, D_MODEL), ODD_MIX ** -0.5),
        'lru_conv_w': nrm((N_ODD, CONV_W, LRU_WIDTH), CONV_W ** -0.5),
        'lru_conv_b': nrm((N_ODD, LRU_WIDTH), 0.02),
        'lru_w_a': nrm((N_ODD, LRU_BLOCKS, LRU_BS, LRU_BS), LRU_BS ** -0.5),
        'lru_b_a': nrm((N_ODD, LRU_WIDTH), 0.02),
        'lru_w_x': nrm((N_ODD, LRU_BLOCKS, LRU_BS, LRU_BS), LRU_BS ** -0.5),
        'lru_b_x': nrm((N_ODD, LRU_WIDTH), 0.02),
        'lru_lambda': jnp.log(a) - jnp.log1p(-a),
        'dn_conv_w': nrm((N_ODD, CONV_W, DN_CONV_CH), CONV_W ** -0.5),
        'dn_a_log': jnp.log(a_heads),
        'dn_dt_bias': dt + jnp.log(-jnp.expm1(-dt)),
        'dn_out_norm': 1.0 + nrm((N_ODD, DN_HEADS * DN_DV), 0.02),
    }


def reference(x_prompt, x_sample, state_ret, state_hgrn, state_lru_h, state_lru_conv, state_dn,
              state_dn_conv, ffn1_norm, ffn1_w_in, ffn1_w_out, mix_norm, ffn2_norm, ffn2_w_in,
              ffn2_w_out, final_norm, even_w_in, even_w_out, ret_out_norm, hg_out_norm,
              hg_lb_logits, odd_w_in, odd_w_out, lru_conv_w, lru_conv_b, lru_w_a, lru_b_a, lru_w_x,
              lru_b_x, lru_lambda, dn_conv_w, dn_a_log, dn_dt_bias, dn_out_norm):
    p = {
        'ffn1_norm': ffn1_norm, 'ffn1_w_in': ffn1_w_in, 'ffn1_w_out': ffn1_w_out,
        'mix_norm': mix_norm, 'ffn2_norm': ffn2_norm, 'ffn2_w_in': ffn2_w_in,
        'ffn2_w_out': ffn2_w_out, 'final_norm': final_norm, 'even_w_in': even_w_in,
        'even_w_out': even_w_out, 'ret_out_norm': ret_out_norm, 'hg_out_norm': hg_out_norm,
        'hg_lb_logits': hg_lb_logits, 'odd_w_in': odd_w_in, 'odd_w_out': odd_w_out,
        'lru_conv_w': lru_conv_w, 'lru_conv_b': lru_conv_b, 'lru_w_a': lru_w_a,
        'lru_b_a': lru_b_a, 'lru_w_x': lru_w_x, 'lru_b_x': lru_b_x, 'lru_lambda': lru_lambda,
        'dn_conv_w': dn_conv_w, 'dn_a_log': dn_a_log, 'dn_dt_bias': dn_dt_bias,
        'dn_out_norm': dn_out_norm,
    }
    f32 = jnp.float32
    bp = x_prompt.shape[0]
    z_ret = jnp.zeros((N_EVEN, bp, RET_HEADS, RET_DK, RET_DV), f32)
    z_hg = jnp.zeros((N_EVEN, bp, HG_HEADS, HG_DK, HG_DV), f32)
    z_lh = jnp.zeros((N_ODD, bp, LRU_WIDTH), f32)
    z_lc = jnp.zeros((N_ODD, bp, CONV_W - 1, LRU_WIDTH), f32)
    z_dn = jnp.zeros((N_ODD, bp, DN_HEADS, DN_DK, DN_DV), f32)
    z_dc = jnp.zeros((N_ODD, bp, CONV_W - 1, DN_CONV_CH), f32)
    pos_p = jnp.arange(x_prompt.shape[1])
    y_prompt, ret_p, hg_p, lh_p, lc_p, dn_p, dc_p = trunk(
        x_prompt, pos_p, z_ret, z_hg, z_lh, z_lc, z_dn, z_dc, p)
    pos_s = PAST_LEN + jnp.arange(x_sample.shape[1])
    y_sample, ret_s, hg_s, lh_s, lc_s, dn_s, dc_s = trunk(
        x_sample, pos_s, state_ret, state_hgrn, state_lru_h, state_lru_conv, state_dn,
        state_dn_conv, p)
    return (y_prompt, y_sample, ret_p, ret_s, hg_p, hg_s, lh_p, lh_s, lc_p, lc_s, dn_p, dn_s,
            dc_p, dc_s)
```

```cpp
#include <hip/hip_runtime.h>
#include <hip/hip_cooperative_groups.h>
#include <cstdio>
namespace cg = cooperative_groups;
namespace pg8 {
#define PG8_LAS __attribute__((address_space(3)))
typedef unsigned short bf16_t;
typedef short bf16x8 __attribute__((ext_vector_type(8)));
typedef float f32x4 __attribute__((ext_vector_type(4)));
typedef unsigned u32x4 __attribute__((ext_vector_type(4)));
constexpr int BM = 256, BK = 64, HALF = 128, HTB = HALF * BK * 2  , STAGE_BYTES = 8 * HTB, NXCD = 8, WGM = 8;

__host__ __device__ __forceinline__ int lds_byte(int r, int c) { const int st = (r >> 4) * 2 + (c >> 5), rr = r & 15, cc = c & 31, ob = rr * 64 + cc * 2; return st * 1024 + (ob ^ (((ob >> 9) & 1) << 5)); }
__host__ __device__ __forceinline__ void stage_rc(int b, int& R, int& C) { const int st = b / 1024, sb = b % 1024, swz = sb ^ (((sb >> 9) & 1) << 5); R = (st >> 1) * 16 + swz / 64; C = (st & 1) * 32 + (swz % 64) / 2; }
__host__ __device__ __forceinline__ int perm32(int rho) { const int n = rho >> 4, i = rho & 15; return 8 * (i >> 2) + 4 * n + (i & 3); }

struct Unit { int pm, pn; };
struct Gemm { const bf16_t* A; const bf16_t* Bt; int M, N, K, lda; };

struct StaticOrder {
    int nM, nN, nwg, G, c;
    __host__ __device__ void init(int M, int N, int G_, int c_) { nM = M / BM; nN = N / BM; nwg = nM * nN; G = G_; c = c_; }
    __host__ __device__ bool next(int i, Unit& u) const {
        const long L = (long)i * G + c; if (L >= nwg) return false;
        int wgid = (int)L; { const int q = nwg / NXCD, r = nwg % NXCD, xcd = wgid % NXCD, off = wgid / NXCD; wgid = (xcd < r ? xcd * (q + 1) : r * (q + 1) + (xcd - r) * q) + off; }
        const int nig = WGM * nN, gid = wgid / nig, fm = gid * WGM, gsz = (nM - fm) < WGM ? (nM - fm) : WGM;
        u.pm = fm + ((wgid % nig) % gsz); u.pn = (wgid % nig) / gsz; return true;
    }
    __device__ __forceinline__ void a_ready(const Unit&) const {}
    __device__ __forceinline__ void done(const Unit&) const {}
};
__device__ __forceinline__ unsigned cvt_pk_bf16(float lo, float hi) { unsigned r; asm volatile("v_cvt_pk_bf16_f32 %0, %1, %2" : "=v"(r) : "v"(lo), "v"(hi)); return r; }
template <class Epi, class Sched, bool STAMP = false>
__device__ __forceinline__ void gemm_phase(PG8_LAS unsigned char* lds, const Gemm g, const Sched& S, const Epi& E, unsigned long long* stamps) {
    int tid_l = threadIdx.x; asm volatile("" : "+v"(tid_l));
    const int tid = tid_l, wid = __builtin_amdgcn_readfirstlane(tid >> 6), lane = tid & 63, wr = wid >> 2, wc = wid & 3, fr = lane & 15, fq = lane >> 4;
    const int K = g.K, nt = K / BK;
    int ts_lo = 0, ts_hi = 0, nts = 0; const unsigned long long rt_entry = STAMP ? (unsigned long long)wall_clock64() : 0ull;
#define PG8_STAMP() do { if (STAMP && wid == 0 && nts < 64) { const unsigned long long _c = (unsigned long long)clock64(); \
        ts_lo = (lane == nts) ? (int)(unsigned)_c : ts_lo; ts_hi = (lane == nts) ? (int)(unsigned)(_c >> 32) : ts_hi; ++nts; } } while (0)
    PG8_STAMP();
    unsigned voffA[2], voffB[2];
#pragma unroll
    for (int i = 0; i < 2; ++i) { int R, C; stage_rc(tid * 16 + i * 8192, R, C); const int Rb = Epi::PERM ? ((R & ~31) + perm32(R & 31)) : R;
        voffA[i] = (unsigned)(R * g.lda + C) * 2u; voffB[i] = (unsigned)(Rb * K + C) * 2u; }
    const size_t kstep = (size_t)(BK * 2);
    const size_t hstepA = (size_t)HALF * g.lda * 2, hstepB = (size_t)HALF * K * 2;
    const size_t tstepA = 2 * hstepA, tstepB = 2 * hstepB;
    const unsigned ldsw = (unsigned)wid * 1024u;
    const int aoff = lds_byte(wr * 64 + fr, fq * 8), boff = lds_byte(wc * 32 + fr, fq * 8);
#define PG8_SA(b, h) (((b) * 2 + (h)) * HTB)
#define PG8_SB(b, h) ((4 + (b) * 2 + (h)) * HTB)
#define PG8_STAGE(bufoff, gbase, voff) do { _Pragma("unroll") for (int _i = 0; _i < 2; ++_i) \
        __builtin_amdgcn_global_load_lds((const unsigned*)((const char*)(gbase) + (voff)[_i]), (PG8_LAS unsigned*)(lds + (bufoff) + ldsw + _i * 8192), 16, 0, 0); } while (0)
#define PG8_LDA(dst, b, h) do { _Pragma("unroll") for (int m = 0; m < 4; ++m) _Pragma("unroll") for (int k = 0; k < 2; ++k) dst[m][k] = *(const PG8_LAS bf16x8*)(lds + PG8_SA(b, h) + aoff + m * 2048 + k * 1024); } while (0)
#define PG8_LDB(dst, b, h) do { _Pragma("unroll") for (int n = 0; n < 2; ++n) _Pragma("unroll") for (int k = 0; k < 2; ++k) dst[n][k] = *(const PG8_LAS bf16x8*)(lds + PG8_SB(b, h) + boff + n * 2048 + k * 1024); } while (0)
#define PG8_MMA(ai, bj, At, Bt) do { __builtin_amdgcn_s_setprio(1); _Pragma("unroll") for (int m = 0; m < 4; ++m) _Pragma("unroll") for (int n = 0; n < 2; ++n) _Pragma("unroll") for (int k = 0; k < 2; ++k) \
        acc[ai][bj][m][n] = __builtin_amdgcn_mfma_f32_16x16x32_bf16(Bt[n][k], At[m][k], acc[ai][bj][m][n], 0, 0, 0); __builtin_amdgcn_s_setprio(0); } while (0)
#define PG8_WAIT_V(n) asm volatile("s_waitcnt vmcnt(" #n ")" ::: "memory")
#define PG8_WAIT_L(n) asm volatile("s_waitcnt lgkmcnt(" #n ")" ::: "memory")
#define PG8_BAR __builtin_amdgcn_s_barrier()
#define PG8_SCHED __builtin_amdgcn_sched_barrier(0)
    Unit cur, nxt; int ui = 0;
    if (!S.next(0, cur)) return;
    f32x4 acc[2][2][4][2];
#pragma unroll
    for (int a = 0; a < 2; ++a)
#pragma unroll
        for (int b = 0; b < 2; ++b)
#pragma unroll
            for (int m = 0; m < 4; ++m)
#pragma unroll
                for (int n = 0; n < 2; ++n) acc[a][b][m][n] = (f32x4){0.f, 0.f, 0.f, 0.f};
    bf16x8 At[4][2], B0[2][2], B1[2][2];
    const char* cA = (const char*)g.A + (size_t)cur.pm * tstepA; const char* cB = (const char*)g.Bt + (size_t)cur.pn * tstepB;
    S.a_ready(cur);
    PG8_STAGE(PG8_SB(0, 0), cB, voffB); PG8_STAGE(PG8_SA(0, 0), cA, voffA); PG8_STAGE(PG8_SB(0, 1), cB + hstepB, voffB); PG8_STAGE(PG8_SA(0, 1), cA + hstepA, voffA);
    if (wr == 1) PG8_BAR;
    PG8_WAIT_V(4); PG8_BAR;
    PG8_STAGE(PG8_SB(1, 0), cB + kstep, voffB); PG8_STAGE(PG8_SA(1, 0), cA + kstep, voffA); PG8_STAGE(PG8_SB(1, 1), cB + hstepB + kstep, voffB);
    PG8_WAIT_V(6); PG8_BAR;
    PG8_STAMP();
    for (;;) {
        const bool has_next = S.next(ui + 1, nxt);
        const char* nA = has_next ? (const char*)g.A + (size_t)nxt.pm * tstepA : cA; const char* nB = has_next ? (const char*)g.Bt + (size_t)nxt.pn * tstepB : cB;
        for (int t = 0; t < nt; t += 2) {
            const bool last = (t == nt - 2);
            const char* a1 = cA + (size_t)(t + 1) * kstep;
            const char* a2 = last ? nA : cA + (size_t)(t + 2) * kstep; const char* b2 = last ? nB : cB + (size_t)(t + 2) * kstep;
            const char* a3 = a2 + kstep; const char* b3 = b2 + kstep;
            if (last && has_next) S.a_ready(nxt);
            PG8_LDB(B0, 0, 0); PG8_SCHED; PG8_LDA(At, 0, 0); PG8_STAGE(PG8_SA(1, 1), a1 + hstepA, voffA);
            PG8_WAIT_L(8); PG8_BAR; PG8_WAIT_L(0); PG8_MMA(0, 0, At, B0); PG8_BAR; PG8_SCHED;
            PG8_LDB(B1, 0, 1); PG8_STAGE(PG8_SB(0, 0), b2, voffB);
            PG8_BAR; PG8_WAIT_L(0); PG8_MMA(0, 1, At, B1); PG8_BAR;
            PG8_LDA(At, 0, 1); PG8_STAGE(PG8_SA(0, 0), a2, voffA);
            PG8_BAR; PG8_WAIT_L(0); PG8_MMA(1, 0, At, B0); PG8_BAR; PG8_SCHED;
            PG8_STAGE(PG8_SB(0, 1), b2 + hstepB, voffB);
            PG8_WAIT_V(6); PG8_BAR; PG8_MMA(1, 1, At, B1); PG8_BAR;
            PG8_LDB(B0, 1, 0); PG8_SCHED; PG8_LDA(At, 1, 0); PG8_STAGE(PG8_SA(0, 1), a2 + hstepA, voffA);
            PG8_WAIT_L(8); PG8_BAR; PG8_WAIT_L(0); PG8_MMA(0, 0, At, B0); PG8_BAR; PG8_SCHED;
            PG8_LDB(B1, 1, 1); PG8_STAGE(PG8_SB(1, 0), b3, voffB);
            PG8_BAR; PG8_WAIT_L(0); PG8_MMA(0, 1, At, B1); PG8_BAR;
            PG8_LDA(At, 1, 1); PG8_STAGE(PG8_SA(1, 0), a3, voffA);
            PG8_BAR; PG8_WAIT_L(0); PG8_MMA(1, 0, At, B0); PG8_BAR; PG8_SCHED;
            PG8_STAGE(PG8_SB(1, 1), b3 + hstepB, voffB);
            PG8_WAIT_V(6); PG8_BAR; PG8_MMA(1, 1, At, B1); PG8_BAR;
        }
        PG8_STAMP();
        if constexpr (!Epi::AFTER_DRAIN) { E(acc, cur, wr, wc, fr, fq); S.done(cur); }
        PG8_STAMP();
        if (!has_next) break;
#pragma unroll
        for (int a = 0; a < 2; ++a)
#pragma unroll
            for (int b = 0; b < 2; ++b)
#pragma unroll
                for (int m = 0; m < 4; ++m)
#pragma unroll
                    for (int n = 0; n < 2; ++n) acc[a][b][m][n] = (f32x4){0.f, 0.f, 0.f, 0.f};
        cur = nxt; cA = nA; cB = nB; ++ui;
    }
    PG8_WAIT_V(0);
    if (wr == 0) PG8_BAR;
    PG8_BAR;
    if constexpr (Epi::AFTER_DRAIN) { E.fused(acc, cur, wr, wc, fr, fq, lds, wid, lane); S.done(cur); }
    PG8_STAMP();
    if (STAMP && wid == 0) { stamps[lane] = lane < nts ? (((unsigned long long)(unsigned)ts_hi << 32) | (unsigned)ts_lo) : 0ull;
        if (lane == 62) stamps[62] = rt_entry; if (lane == 63) stamps[63] = (unsigned long long)wall_clock64(); }
#undef PG8_STAMP
#undef PG8_SA
#undef PG8_SB
#undef PG8_STAGE
#undef PG8_LDA
#undef PG8_LDB
#undef PG8_MMA
#undef PG8_WAIT_V
#undef PG8_WAIT_L
#undef PG8_BAR
#undef PG8_SCHED
}
}
#define LAS __attribute__((address_space(3)))
typedef pg8::bf16_t bf16_t;
typedef pg8::bf16x8 bf16x8;
typedef pg8::f32x4 f32x4;
typedef unsigned u32x2 __attribute__((ext_vector_type(2)));
typedef unsigned u32x4 __attribute__((ext_vector_type(4)));
constexpr int MTOK = 17408, MP = 16384, DM = 1024, FF = 2816, NCH = 272, NTH = 512;
constexpr int ZE = 4096, ZO = 3328;
constexpr float EPS = 1e-6f;
constexpr int LDS_BYTES = 147456;
constexpr size_t W_F1IN = 0, W_F1OUT = W_F1IN + (size_t)5632 * 1024 * 2, W_F2IN = W_F1OUT + (size_t)1024 * 2816 * 2, W_F2OUT = W_F2IN + (size_t)5632 * 1024 * 2,
                 W_MIN = W_F2OUT + (size_t)1024 * 2816 * 2, W_MOUT = W_MIN + (size_t)4096 * 1024 * 2, OFF_XB = W_MOUT + (size_t)1024 * 1024 * 2,
                 OFF_Z = OFF_XB + (size_t)MTOK * 1024 * 2, OFF_TQ = OFF_Z + (size_t)MTOK * ZO * 2, OFF_ATT = OFF_Z + (size_t)MTOK * ZE * 2,
                 OFF_ROPE = OFF_ATT + (size_t)2176 * 8192, OFF_SS = OFF_ROPE + (size_t)4096 * 64 * 8, OFF_SNAP = OFF_SS + (size_t)7 * MTOK * 4,
                 OFF_DEC = OFF_SNAP + (size_t)NCH * 3 * ZO * 2, OFF_LRU = OFF_DEC + (size_t)1088 * 128 * 4, OFF_LRUW = OFF_LRU + (size_t)3 * NCH * 512 * 4,
                 WS_END = OFF_LRUW + (size_t)2 * 8 * 64 * 64 * 2;
constexpr size_t O_RETP = 17825792, O_RETS = 18087936, O_HGP = 19136512, O_HGS = 19398656, O_LHP = 20447232, O_LHS = 20449280, O_LCP = 20457472, O_LCS = 20463616,
                 O_DNP = 20488192, O_DNS = 20750336, O_DCP = 21798912, O_DCS = 21817344;
struct Params { const float* in[34]; float* out; unsigned char* ws; int lo, hi; };

__device__ __forceinline__ int ltid() { int t = threadIdx.x; asm volatile("" : "+v"(t)); return t; }
__device__ __forceinline__ float bf2f(unsigned v) { return __uint_as_float(v << 16); }
__device__ __forceinline__ unsigned f2bf(float f) { unsigned u = __float_as_uint(f); u += 0x7FFFu + ((u >> 16) & 1u); return u >> 16; }
__device__ __forceinline__ unsigned pk2(float a, float b) { return f2bf(a) | (f2bf(b) << 16); }
__device__ __forceinline__ float sigm(float x) { return 1.0f / (1.0f + __expf(-x)); }
__device__ __forceinline__ float silu(float x) { return x * sigm(x); }
__device__ __forceinline__ float softplus(float x) { return x > 20.f ? x : log1pf(__expf(x)); }

template <int KD> __device__ __forceinline__ f32x4 mma16(const LAS bf16_t* X, int ldx, const LAS bf16_t* Y, int ldy, f32x4 acc, int lane) {
    const int r = lane & 15, q = lane >> 4;
    const LAS bf16_t* xp = X + r * ldx + 8 * q; const LAS bf16_t* yp = Y + r * ldy + 8 * q;
#pragma unroll
    for (int k = 0; k < KD; k += 32) {
        const bf16x8 xa = *(const LAS bf16x8*)(xp + k); const bf16x8 yb = *(const LAS bf16x8*)(yp + k);
        acc = __builtin_amdgcn_mfma_f32_16x16x32_bf16(yb, xa, acc, 0, 0, 0);
    }
    return acc;
}

struct EpiSwiGLU {
    static constexpr bool PERM = false, AFTER_DRAIN = false;
    bf16_t* act; const float* ss;
    __device__ __forceinline__ void operator()(const f32x4 (&acc)[2][2][4][2], const pg8::Unit& u, int wr, int wc, int fr, int fq) const {
#pragma unroll
        for (int ai = 0; ai < 2; ++ai)
#pragma unroll
            for (int m = 0; m < 4; ++m) {
                const int row = u.pm * 256 + ai * 128 + wr * 64 + m * 16 + fr; const float rs = rsqrtf(ss[row] * (1.0f / 1024.0f) + EPS);
#pragma unroll
                for (int n = 0; n < 2; ++n) { const f32x4 g = acc[ai][0][m][n] * rs, up = acc[ai][1][m][n] * rs;
                    u32x2 w; w.x = pk2(silu(g[0]) * up[0], silu(g[1]) * up[1]); w.y = pk2(silu(g[2]) * up[2], silu(g[3]) * up[3]);
                    *(u32x2*)(act + (size_t)row * FF + u.pn * 128 + wc * 32 + n * 16 + fq * 4) = w; }
            }
    }
};
struct EpiResid {
    static constexpr bool PERM = false, AFTER_DRAIN = false;
    float* x; bf16_t* xb; float* ssn; float scale;
    __device__ __forceinline__ void operator()(const f32x4 (&acc)[2][2][4][2], const pg8::Unit& u, int wr, int wc, int fr, int fq) const {
#pragma unroll
        for (int ai = 0; ai < 2; ++ai)
#pragma unroll
            for (int m = 0; m < 4; ++m) {
                const int row = u.pm * 256 + ai * 128 + wr * 64 + m * 16 + fr; float sq = 0.f;
#pragma unroll
                for (int bj = 0; bj < 2; ++bj)
#pragma unroll
                    for (int n = 0; n < 2; ++n) { const size_t o = (size_t)row * DM + u.pn * 256 + bj * 128 + wc * 32 + n * 16 + fq * 4;
                        const f32x4 v = *(const f32x4*)(x + o) + acc[ai][bj][m][n] * scale; *(f32x4*)(x + o) = v;
                        u32x2 w; w.x = pk2(v[0], v[1]); w.y = pk2(v[2], v[3]); *(u32x2*)(xb + o) = w;
                        sq += v[0] * v[0] + v[1] * v[1] + v[2] * v[2] + v[3] * v[3]; }
                sq += __shfl_xor(sq, 16); sq += __shfl_xor(sq, 32);
                if (fq == 0) atomicAdd(ssn + row, sq);
            }
    }
};
struct EpiZ {
    static constexpr bool PERM = false, AFTER_DRAIN = false;
    bf16_t* z; int ldz; const float* ss; bf16_t* snap;
    __device__ __forceinline__ void operator()(const f32x4 (&acc)[2][2][4][2], const pg8::Unit& u, int wr, int wc, int fr, int fq) const {
#pragma unroll
        for (int ai = 0; ai < 2; ++ai)
#pragma unroll
            for (int m = 0; m < 4; ++m) {
                const int row = u.pm * 256 + ai * 128 + wr * 64 + m * 16 + fr; const float rs = rsqrtf(ss[row] * (1.0f / 1024.0f) + EPS);
#pragma unroll
                for (int bj = 0; bj < 2; ++bj)
#pragma unroll
                    for (int n = 0; n < 2; ++n) { const int col = u.pn * 256 + bj * 128 + wc * 32 + n * 16 + fq * 4; const f32x4 v = acc[ai][bj][m][n] * rs;
                        u32x2 w; w.x = pk2(v[0], v[1]); w.y = pk2(v[2], v[3]); *(u32x2*)(z + (size_t)row * ldz + col) = w;
                        if (snap && (row & 63) >= 61) *(u32x2*)(snap + (size_t)((row >> 6) * 3 + (row & 63) - 61) * ldz + col) = w; }
            }
    }
};
__device__ void phase_prep(const Params& p, LAS unsigned char* lds) {
    const int tid = ltid(), lane = tid & 63, wv = __builtin_amdgcn_readfirstlane(tid >> 6), G = gridDim.x, b = blockIdx.x;
    float* xres = p.out; bf16_t* xb = (bf16_t*)(p.ws + OFF_XB); float* ss = (float*)(p.ws + OFF_SS);
    for (size_t i = (size_t)b * NTH + tid; i < (size_t)6 * MTOK; i += (size_t)G * NTH) ss[MTOK + i] = 0.f;
    for (int row = b * 8 + wv; row < MTOK; row += G * 8) {
        const float* src = row < MP ? p.in[0] + (size_t)row * DM : p.in[1] + (size_t)(row - MP) * DM;
        float sq = 0.f;
#pragma unroll
        for (int i = 0; i < 4; ++i) { const f32x4 v = *(const f32x4*)(src + i * 256 + lane * 4); *(f32x4*)(xres + (size_t)row * DM + i * 256 + lane * 4) = v;
            u32x2 w; w.x = pk2(v[0], v[1]); w.y = pk2(v[2], v[3]); *(u32x2*)(xb + (size_t)row * DM + i * 256 + lane * 4) = w;
            sq += v[0] * v[0] + v[1] * v[1] + v[2] * v[2] + v[3] * v[3]; }
#pragma unroll
        for (int o = 32; o >= 1; o >>= 1) sq += __shfl_xor(sq, o);
        if (lane == 0) ss[row] = sq;
    }
    float2* cs = (float2*)(p.ws + OFF_ROPE);
    for (int i = b * NTH + tid; i < 4096 * 64; i += G * NTH) { const int pos = i >> 6, k = i & 63;
        const float fr = exp2f(-(float)k * (13.287712379549449f / 64.0f)); const float a = (float)pos * fr; cs[i] = make_float2(cosf(a), sinf(a)); }
    bf16_t* lw = (bf16_t*)(p.ws + OFF_LRUW);
    for (int i = b * NTH + tid; i < 2 * 8 * 64 * 64; i += G * NTH) { const int g = i >> 15, n = (i >> 12) & 7, e = (i >> 6) & 63, d = i & 63;
        lw[i] = (bf16_t)f2bf((g ? p.in[27] : p.in[25])[(n * 64 + d) * 64 + e]); }
}
template <int MAPMODE> __device__ void wconv(const float* src, const float* gain, bf16_t* dst, int K, int N, int NP, LAS unsigned char* lds, int& work) {
    LAS float* T = (LAS float*)lds;
    const int tid = ltid(), G = gridDim.x, b = blockIdx.x; const int nkt = K / 64, nnt = NP / 64;
    for (int tile = 0; tile < nkt * nnt; ++tile, ++work) {
        if (work % G != b) continue;
        const int kt = tile % nkt, ntl = tile / nkt;
        __syncthreads();
#pragma unroll
        for (int i = 0; i < 8; ++i) { const int e = tid + i * NTH, kk = e >> 6, nn = e & 63; const int k = kt * 64 + kk, n = ntl * 64 + nn;
            float v = 0.f; if (n < N) { v = src[(size_t)k * N + n]; if (gain) v *= gain[k]; } T[kk * 65 + nn] = v; }
        __syncthreads();
#pragma unroll
        for (int i = 0; i < 4; ++i) { const int e = tid + i * NTH, nn = e >> 5, k2 = (e & 31) * 2; const int n = ntl * 64 + nn;
            int r = n; if (MAPMODE == 1) r = n < FF ? (n >> 7) * 256 + (n & 127) : ((n - FF) >> 7) * 256 + 128 + ((n - FF) & 127);
            *(unsigned*)(dst + (size_t)r * K + kt * 64 + k2) = pk2(T[k2 * 65 + nn], T[(k2 + 1) * 65 + nn]); }
    }
}
__device__ void phase_weights(const Params& p, int l, LAS unsigned char* lds) {
    unsigned char* ws = p.ws; int work = 0;
    wconv<1>(p.in[9] + (size_t)l * DM * 2 * FF, p.in[8] + l * DM, (bf16_t*)(ws + W_F1IN), DM, 2 * FF, 2 * FF, lds, work);
    wconv<0>(p.in[10] + (size_t)l * FF * DM, nullptr, (bf16_t*)(ws + W_F1OUT), FF, DM, DM, lds, work);
    wconv<1>(p.in[13] + (size_t)l * DM * 2 * FF, p.in[12] + l * DM, (bf16_t*)(ws + W_F2IN), DM, 2 * FF, 2 * FF, lds, work);
    wconv<0>(p.in[14] + (size_t)l * FF * DM, nullptr, (bf16_t*)(ws + W_F2OUT), FF, DM, DM, lds, work);
    if (l == 0) { wconv<0>(p.in[16], p.in[11], (bf16_t*)(ws + W_MIN), DM, ZE, ZE, lds, work); wconv<0>(p.in[17], nullptr, (bf16_t*)(ws + W_MOUT), DM, DM, DM, lds, work); }
    else { wconv<0>(p.in[21], p.in[11] + DM, (bf16_t*)(ws + W_MIN), DM, 3080, ZO, lds, work); wconv<0>(p.in[22], nullptr, (bf16_t*)(ws + W_MOUT), DM, DM, DM, lds, work); }
    __syncthreads();
}
template <class Epi> __device__ __forceinline__ void run_gemm(LAS unsigned char* lds, const bf16_t* A, int lda, const bf16_t* Bt, int N, int K, const Epi& E) {
    pg8::Gemm g{A, Bt, MTOK, N, K, lda}; pg8::StaticOrder S; S.init(MTOK, N, (int)gridDim.x, (int)blockIdx.x);
    pg8::gemm_phase<Epi, pg8::StaticOrder, false>(lds, g, S, E, nullptr);
}
__device__ void e1_ret(const Params& p, int c, int h, LAS unsigned char* lds) {
    LAS bf16_t* Q = (LAS bf16_t*)lds; LAS bf16_t* Kk = Q + 64 * 136; LAS bf16_t* KT = Kk + 64 * 136;
    const int tid = ltid(), lane = tid & 63, wv = __builtin_amdgcn_readfirstlane(tid >> 6);
    bf16_t* z = (bf16_t*)(p.ws + OFF_Z) + (size_t)c * 64 * ZE; const float2* cs = (const float2*)(p.ws + OFF_ROPE);
    const float lg = log1pf(-exp2f(-5.0f - (float)h)); const int pos0 = c < 256 ? (c & 63) * 64 : 2048;
    const int qc = h * 128, kc = 512 + h * 128;
    __syncthreads();
#pragma unroll
    for (int i = 0; i < 4; ++i) { const int idx = tid + i * NTH, t = idx >> 5, d = (idx & 31) * 2;
        const bf16_t* zr = z + (size_t)t * ZE; const unsigned q1 = *(const unsigned*)(zr + qc + d), q2 = *(const unsigned*)(zr + qc + 64 + d), k1 = *(const unsigned*)(zr + kc + d), k2 = *(const unsigned*)(zr + kc + 64 + d);
        const f32x4 cv = *(const f32x4*)(cs + (size_t)(pos0 + t) * 64 + d);
        const float qd = __expf(lg * (float)(t + 1)) * 0.08838834764831845f, kd = __expf(lg * (float)(63 - t));
        float a0 = bf2f(q1 & 0xffff), a1 = bf2f(q1 >> 16), b0 = bf2f(q2 & 0xffff), b1 = bf2f(q2 >> 16);
        float r0 = a0 * cv[0] - b0 * cv[1], r1 = a1 * cv[2] - b1 * cv[3], s0 = a0 * cv[1] + b0 * cv[0], s1 = a1 * cv[3] + b1 * cv[2];
        *(LAS unsigned*)(Q + t * 136 + d) = pk2(r0 * 0.08838834764831845f, r1 * 0.08838834764831845f); *(LAS unsigned*)(Q + t * 136 + 64 + d) = pk2(s0 * 0.08838834764831845f, s1 * 0.08838834764831845f);
        *(unsigned*)(z + (size_t)t * ZE + qc + d) = pk2(r0 * qd, r1 * qd); *(unsigned*)(z + (size_t)t * ZE + qc + 64 + d) = pk2(s0 * qd, s1 * qd);
        a0 = bf2f(k1 & 0xffff); a1 = bf2f(k1 >> 16); b0 = bf2f(k2 & 0xffff); b1 = bf2f(k2 >> 16);
        r0 = a0 * cv[0] - b0 * cv[1]; r1 = a1 * cv[2] - b1 * cv[3]; s0 = a0 * cv[1] + b0 * cv[0]; s1 = a1 * cv[3] + b1 * cv[2];
        *(LAS unsigned*)(Kk + t * 136 + d) = pk2(r0, r1); *(LAS unsigned*)(Kk + t * 136 + 64 + d) = pk2(s0, s1);
        KT[d * 72 + t] = (bf16_t)f2bf(r0 * kd); KT[(d + 1) * 72 + t] = (bf16_t)f2bf(r1 * kd); KT[(d + 64) * 72 + t] = (bf16_t)f2bf(s0 * kd); KT[(d + 65) * 72 + t] = (bf16_t)f2bf(s1 * kd); }
    __syncthreads();
    bf16_t* att = (bf16_t*)(p.ws + OFF_ATT) + (size_t)(c * 8 + h) * 4096;
#pragma unroll
    for (int i = 0; i < 2; ++i) { const int tile = wv * 2 + i, ti = tile >> 2, sj = tile & 3;
        f32x4 a = mma16<128>(Q + ti * 16 * 136, 136, Kk + sj * 16 * 136, 136, (f32x4){0.f, 0.f, 0.f, 0.f}, lane);
        const int t = ti * 16 + (lane & 15), s = sj * 16 + 4 * (lane >> 4);
        u32x2 w; w.x = pk2(a[0] * __expf(lg * fabsf((float)(t - s))), a[1] * __expf(lg * fabsf((float)(t - s - 1)))); w.y = pk2(a[2] * __expf(lg * fabsf((float)(t - s - 2))), a[3] * __expf(lg * fabsf((float)(t - s - 3))));
        *(u32x2*)(att + t * 64 + s) = w; }
#pragma unroll
    for (int i = 0; i < 2; ++i) { const int pc = tid + i * NTH, d = pc >> 3, s0 = (pc & 7) * 8;
        *(u32x4*)(z + (size_t)(d >> 1) * ZE + kc + (d & 1) * 64 + s0) = *(const LAS u32x4*)(KT + d * 72 + s0); }
}
__device__ void e1_hg(const Params& p, int c, int h, LAS unsigned char* lds) {
    LAS float* Qf = (LAS float*)lds; LAS float* Kf = Qf + 64 * 132; LAS float* Bf = Kf + 64 * 132; LAS bf16_t* KT = (LAS bf16_t*)(Bf + 64 * 132); LAS float* Pp = (LAS float*)(KT + 128 * 72);
    const int tid = ltid(), lane = tid & 63;
    bf16_t* z = (bf16_t*)(p.ws + OFF_Z) + (size_t)c * 64 * ZE; const int qc = 2048 + h * 128, fc = 2560 + h * 128;
    const float* lbl = p.in[20];
    __syncthreads();
#pragma unroll
    for (int i = 0; i < 8; ++i) { const int idx = tid + i * NTH, t = idx >> 6, d = (idx & 63) * 2;
        const unsigned qv = *(const unsigned*)(z + (size_t)t * ZE + qc + d), fv = *(const unsigned*)(z + (size_t)t * ZE + fc + d);
#pragma unroll
        for (int j = 0; j < 2; ++j) { const float hq = bf2f(j ? qv >> 16 : qv & 0xffff), hf = bf2f(j ? fv >> 16 : fv & 0xffff);
            const float lb = sigm(lbl[h * 128 + d + j] - lbl[512 + h * 128 + d + j]); const float sg = sigm(hf);
            const float f = lb + (1.0f - lb) * sg; Qf[t * 132 + d + j] = silu(hq); Kf[t * 132 + d + j] = (1.0f - lb) * (1.0f - sg); Bf[t * 132 + d + j] = __log2f(f); } }
    __syncthreads();
    { const int d = tid >> 2, pq = tid & 3; float v[16]; float run = 0.f;
#pragma unroll
      for (int i = 0; i < 16; ++i) { run += Bf[(pq * 16 + i) * 132 + d]; v[i] = run; }
      const float t0 = __shfl(run, (lane & ~3)), t1 = __shfl(run, (lane & ~3) + 1), t2 = __shfl(run, (lane & ~3) + 2);
      const float off = (pq > 0 ? t0 : 0.f) + (pq > 1 ? t1 : 0.f) + (pq > 2 ? t2 : 0.f);
#pragma unroll
      for (int i = 0; i < 16; ++i) Bf[(pq * 16 + i) * 132 + d] = v[i] + off; }
    __syncthreads();
    const int half = tid >= 256 ? 1 : 0, bid = tid - half * 256; int ti = 0, sj = 0; const bool act = bid < 136;
    if (act) { int r = 0; while ((r + 1) * (r + 2) / 2 <= bid) ++r; ti = r; sj = bid - r * (r + 1) / 2; }
    float acc[4][4];
#pragma unroll
    for (int a = 0; a < 4; ++a)
#pragma unroll
        for (int s = 0; s < 4; ++s) acc[a][s] = 0.f;
    if (act) {
        for (int d = half * 64; d < half * 64 + 64; d += 4) {
            f32x4 q[4], bt[4], k[4], bs[4];
#pragma unroll
            for (int a = 0; a < 4; ++a) { q[a] = *(const LAS f32x4*)(Qf + (ti * 4 + a) * 132 + d); bt[a] = *(const LAS f32x4*)(Bf + (ti * 4 + a) * 132 + d); k[a] = *(const LAS f32x4*)(Kf + (sj * 4 + a) * 132 + d); bs[a] = *(const LAS f32x4*)(Bf + (sj * 4 + a) * 132 + d); }
#pragma unroll
            for (int a = 0; a < 4; ++a)
#pragma unroll
                for (int s = 0; s < 4; ++s)
#pragma unroll
                    for (int j = 0; j < 4; ++j) acc[a][s] += q[a][j] * k[s][j] * __builtin_amdgcn_exp2f(fminf(bt[a][j] - bs[s][j], 0.f));
        }
        if (half) {
#pragma unroll
            for (int a = 0; a < 4; ++a)
#pragma unroll
                for (int s = 0; s < 4; ++s) Pp[bid * 16 + a * 4 + s] = acc[a][s]; }
    }
    __syncthreads();
    bf16_t* att = (bf16_t*)(p.ws + OFF_ATT) + (size_t)(c * 8 + 4 + h) * 4096;
    if (!half && act) {
#pragma unroll
        for (int a = 0; a < 4; ++a) { const int t = ti * 4 + a; float o[4];
#pragma unroll
            for (int s = 0; s < 4; ++s) o[s] = (sj * 4 + s <= t) ? acc[a][s] + Pp[bid * 16 + a * 4 + s] : 0.f;
            u32x2 w; w.x = pk2(o[0], o[1]); w.y = pk2(o[2], o[3]); *(u32x2*)(att + t * 64 + sj * 4) = w; } }
    if (!half && !act && bid < 256) {
        int r = 0, q2 = bid - 136; while ((r + 1) * (r + 2) / 2 <= q2) ++r; const int cj = r + 1, ri = q2 - r * (r + 1) / 2;
        u32x2 w; w.x = 0u; w.y = 0u;
#pragma unroll
        for (int a = 0; a < 4; ++a) *(u32x2*)(att + (ri * 4 + a) * 64 + cj * 4) = w; }
#pragma unroll
    for (int i = 0; i < 8; ++i) { const int idx = tid + i * NTH, t = idx >> 6, d = (idx & 63) * 2;
        const float b0 = Bf[t * 132 + d], b1 = Bf[t * 132 + d + 1], e0 = Bf[63 * 132 + d], e1 = Bf[63 * 132 + d + 1];
        *(unsigned*)(z + (size_t)t * ZE + qc + d) = pk2(Qf[t * 132 + d] * __builtin_amdgcn_exp2f(b0), Qf[t * 132 + d + 1] * __builtin_amdgcn_exp2f(b1));
        KT[d * 72 + t] = (bf16_t)f2bf(Kf[t * 132 + d] * __builtin_amdgcn_exp2f(e0 - b0)); KT[(d + 1) * 72 + t] = (bf16_t)f2bf(Kf[t * 132 + d + 1] * __builtin_amdgcn_exp2f(e1 - b1)); }
    if (tid < 128) ((float*)(p.ws + OFF_DEC))[(size_t)(c * 4 + h) * 128 + tid] = __builtin_amdgcn_exp2f(Bf[63 * 132 + tid]);
    __syncthreads();
#pragma unroll
    for (int i = 0; i < 2; ++i) { const int pc = tid + i * NTH, d = pc >> 3, s0 = (pc & 7) * 8;
        *(u32x4*)(z + (size_t)(d >> 1) * ZE + fc + (d & 1) * 64 + s0) = *(const LAS u32x4*)(KT + d * 72 + s0); }
}
__device__ void phase_e1(const Params& p, LAS unsigned char* lds) {
    for (int it = blockIdx.x; it < NCH * 8; it += gridDim.x) { const int c = it >> 3, hh = it & 7; if (hh < 4) e1_ret(p, c, hh, lds); else e1_hg(p, c, hh - 4, lds); }
}
__device__ void e2_run(const Params& p, int type, int c0, int nch, int h, int sl, const float* s_in, float* s_out, LAS unsigned char* lds) {
    LAS bf16_t* XA = (LAS bf16_t*)lds; LAS bf16_t* YB = XA + 64 * 200; LAS bf16_t* KT = YB + 16 * 200;
    const int tid = ltid(), lane = tid & 63, wv = __builtin_amdgcn_readfirstlane(tid >> 6), r = lane & 15, q = lane >> 4;
    bf16_t* zb = (bf16_t*)(p.ws + OFF_Z); const bf16_t* attb = (const bf16_t*)(p.ws + OFF_ATT); const float* decb = (const float*)(p.ws + OFF_DEC);
    const int qc = type ? 2048 + h * 128 : h * 128, kc = type ? 2560 + h * 128 : 512 + h * 128, vc = (type ? 3072 : 1024) + h * 128 + sl * 16;
    const float dret = __expf(64.0f * log1pf(-exp2f(-5.0f - (float)h)));
    f32x4 S = (f32x4){0.f, 0.f, 0.f, 0.f};
    if (s_in) {
#pragma unroll
        for (int j = 0; j < 4; ++j) S[j] = s_in[(size_t)(16 * wv + 4 * q + j) * 128 + sl * 16 + r]; }
    __syncthreads();
    { u32x2 w; w.x = pk2(S[0], S[1]); w.y = pk2(S[2], S[3]); *(LAS u32x2*)(YB + r * 200 + 64 + 16 * wv + 4 * q) = w; }
    u32x4 ra, rq[2], rk[2], rv;
#define E2_LD(cc) do { const bf16_t* z_ = zb + (size_t)(cc) * 64 * ZE; \
        ra = *(const u32x4*)(attb + (size_t)((cc) * 8 + type * 4 + h) * 4096 + tid * 8); \
        _Pragma("unroll") for (int i_ = 0; i_ < 2; ++i_) { const int pc_ = tid + i_ * NTH; rq[i_] = *(const u32x4*)(z_ + (size_t)(pc_ >> 4) * ZE + qc + (pc_ & 15) * 8); rk[i_] = *(const u32x4*)(z_ + (size_t)(pc_ >> 4) * ZE + kc + (pc_ & 15) * 8); } \
        if (tid < 128) rv = *(const u32x4*)(z_ + (size_t)(tid >> 1) * ZE + vc + (tid & 1) * 8); } while (0)
    rv = (u32x4){0u, 0u, 0u, 0u};
    E2_LD(c0);
    for (int n = 0; n < nch; ++n) {
        const int c = c0 + n;
        *(LAS u32x4*)(XA + (tid >> 3) * 200 + (tid & 7) * 8) = ra;
#pragma unroll
        for (int i = 0; i < 2; ++i) { const int pc = tid + i * NTH; *(LAS u32x4*)(XA + (pc >> 4) * 200 + 64 + (pc & 15) * 8) = rq[i];
            const int off = (pc & 15) * 8; *(LAS u32x4*)(KT + (2 * (pc >> 4) + (off >> 6)) * 72 + (off & 63)) = rk[i]; }
        if (tid < 128) { const int t = tid >> 1, e0 = (tid & 1) * 8;
#pragma unroll
            for (int j = 0; j < 4; ++j) { YB[(e0 + 2 * j) * 200 + t] = (bf16_t)(rv[j] & 0xffff); YB[(e0 + 2 * j + 1) * 200 + t] = (bf16_t)(rv[j] >> 16); } }
        f32x4 dv = (f32x4){dret, dret, dret, dret};
        if (type) dv = *(const f32x4*)(decb + (size_t)(c * 4 + h) * 128 + 16 * wv + 4 * q);
        __syncthreads();
        if (n + 1 < nch) E2_LD(c + 1);
        if (wv < 4) {
            const f32x4 o = mma16<192>(XA + wv * 16 * 200, 200, YB, 200, (f32x4){0.f, 0.f, 0.f, 0.f}, lane);
            u32x2 w; w.x = pk2(o[0], o[1]); w.y = pk2(o[2], o[3]);
            *(u32x2*)(zb + (size_t)(c * 64 + 16 * wv + r) * ZE + vc + 4 * q) = w; }
        S = mma16<64>(YB, 200, KT + wv * 16 * 72, 72, S * dv, lane);
        __syncthreads();
        { u32x2 w; w.x = pk2(S[0], S[1]); w.y = pk2(S[2], S[3]); *(LAS u32x2*)(YB + r * 200 + 64 + 16 * wv + 4 * q) = w; }
    }
#pragma unroll
    for (int j = 0; j < 4; ++j) s_out[(size_t)(16 * wv + 4 * q + j) * 128 + sl * 16 + r] = S[j];
}
__device__ void phase_e2(const Params& p, LAS unsigned char* lds) {
    for (int it = blockIdx.x; it < 1280; it += gridDim.x) {
        if (it < 256) { const int g = it & 31, sl = it >> 5, type = g >> 4, seq = (g >> 2) & 3, h = g & 3;
            e2_run(p, type, seq * 64, 64, h, sl, nullptr, p.out + (type ? O_HGP : O_RETP) + (size_t)(seq * 4 + h) * 16384, lds); }
        else { const int j = it - 256, g = j & 127, sl = j >> 7, type = g >> 6, seq = (g >> 2) & 15, h = g & 3;
            e2_run(p, type, 256 + seq, 1, h, sl, p.in[type ? 3 : 2] + (size_t)(seq * 4 + h) * 16384, p.out + (type ? O_HGS : O_RETS) + (size_t)(seq * 4 + h) * 16384, lds); }
    }
}
__device__ void phase_e3(const Params& p) {
    const int lane = ltid() & 63, wv = __builtin_amdgcn_readfirstlane(ltid() >> 6); bf16_t* z = (bf16_t*)(p.ws + OFF_Z); const int stride = gridDim.x * 8;
    for (int base = blockIdx.x * 8 + wv; base < MTOK * 8; base += stride * 4) {
        unsigned ov[4], gv[4];
#pragma unroll
        for (int u = 0; u < 4; ++u) { const int it = base + u * stride; ov[u] = 0; gv[u] = 0;
            if (it < MTOK * 8) { const int m = it >> 3, hh = it & 7, oc = (hh < 4 ? 1024 + hh * 128 : 3072 + (hh - 4) * 128) + 2 * lane;
                ov[u] = *(const unsigned*)(z + (size_t)m * ZE + oc); gv[u] = *(const unsigned*)(z + (size_t)m * ZE + oc + 512); } }
#pragma unroll
        for (int u = 0; u < 4; ++u) { const int it = base + u * stride;
            const float o0 = bf2f(ov[u] & 0xffff), o1 = bf2f(ov[u] >> 16), g0 = bf2f(gv[u] & 0xffff), g1 = bf2f(gv[u] >> 16);
            float sq = o0 * o0 + o1 * o1;
#pragma unroll
            for (int o = 32; o >= 1; o >>= 1) sq += __shfl_xor(sq, o);
            if (it < MTOK * 8) { const int m = it >> 3, hh = it & 7; const float rs = rsqrtf(sq * (1.0f / 128.0f) + EPS);
                const float* gn = (hh < 4 ? p.in[18] : p.in[19]) + (hh & 3) * 128 + 2 * lane;
                *(unsigned*)(z + (size_t)m * ZE + hh * 128 + 2 * lane) = pk2(o0 * rs * gn[0] * silu(g0), o1 * rs * gn[1] * silu(g1)); } }
    }
}
__device__ void o1_delta(const Params& p, int c, int h, LAS unsigned char* lds) {
    LAS float* Qf = (LAS float*)lds; LAS float* Kf = Qf + 64 * 129; LAS float* gS = Kf + 64 * 129;
    LAS bf16_t* Qd = (LAS bf16_t*)(gS + 256); LAS bf16_t* Kd = Qd + 64 * 136; LAS bf16_t* KT = Kd + 64 * 136; LAS float* Xs = (LAS float*)(KT + 128 * 72); LAS float* Af = Qf;
    const int tid = ltid(), lane = tid & 63, wv = __builtin_amdgcn_readfirstlane(tid >> 6), r = lane & 15, q = lane >> 4;
    bf16_t* z = (bf16_t*)(p.ws + OFF_Z) + (size_t)c * 64 * ZO; const bf16_t* snap = (const bf16_t*)(p.ws + OFF_SNAP);
    const int item = c * 4 + h; const bool lastc = (c >= 256) || ((c & 63) == 63); const int seq = c >= 256 ? c - 256 : c >> 6;
    __syncthreads();
    if (tid < 384) { const int which = tid >> 7, d = tid & 127, col = 1024 + which * 512 + h * 128 + d, cch = which * 512 + h * 128 + d;
        const float* cw = p.in[30]; const float w0 = cw[cch], w1 = cw[1536 + cch], w2 = cw[2 * 1536 + cch], w3 = cw[3 * 1536 + cch];
        float x3 = 0.f, x2 = 0.f, x1 = 0.f;
        if (c >= 256) { const float* st = p.in[7] + (size_t)(c - 256) * 3 * 1536 + cch; x3 = st[0]; x2 = st[1536]; x1 = st[2 * 1536]; }
        else if (c & 63) { const bf16_t* sp = snap + (size_t)(c - 1) * 3 * ZO + col; x3 = bf2f(sp[0]); x2 = bf2f(sp[ZO]); x1 = bf2f(sp[2 * ZO]); }
        float* dco = p.out + (c >= 256 ? O_DCS : O_DCP) + (size_t)seq * 3 * 1536 + cch;
        for (int t0 = 0; t0 < 64; t0 += 8) { float xv[8];
#pragma unroll
            for (int j = 0; j < 8; ++j) xv[j] = bf2f(z[(size_t)(t0 + j) * ZO + col]);
#pragma unroll
            for (int j = 0; j < 8; ++j) { const int t = t0 + j; const float x = xv[j]; const float y = w3 * x + w2 * x1 + w1 * x2 + w0 * x3; x3 = x2; x2 = x1; x1 = x; const float s = silu(y);
                if (which == 0) Qf[t * 129 + d] = s; else if (which == 1) Kf[t * 129 + d] = s; else z[(size_t)t * ZO + col] = (bf16_t)f2bf(s);
                if (lastc && t >= 61) dco[(size_t)(t - 61) * 1536] = x; } }
    }
    __syncthreads();
    { const int row = tid >> 2, pq = tid & 3, t = row & 63; LAS float* src = (row < 64 ? Qf : Kf) + t * 129 + pq * 32; float sq = 0.f;
#pragma unroll
      for (int i = 0; i < 32; ++i) sq += src[i] * src[i];
      sq += __shfl_xor(sq, 1); sq += __shfl_xor(sq, 2);
      const float rn = rsqrtf(sq + EPS); LAS bf16_t* dst = (row < 64 ? Qd : Kd) + t * 136 + pq * 32; const float sc = row < 64 ? rn * 0.08838834764831845f : rn;
#pragma unroll
      for (int i = 0; i < 32; i += 2) *(LAS unsigned*)(dst + i) = pk2(src[i] * sc, src[i + 1] * sc);
      if (row >= 64 && pq == 0) gS[128 + t] = rn; }
    if (wv == 0) { const float db = bf2f(z[(size_t)lane * ZO + 3072 + h]), da = bf2f(z[(size_t)lane * ZO + 3076 + h]);
        float g = -__expf(p.in[31][h]) * softplus(da + p.in[32][h]);
#pragma unroll
        for (int o = 1; o < 64; o <<= 1) { const float u = __shfl_up(g, o); if (lane >= o) g += u; }
        gS[lane] = g; gS[64 + lane] = sigm(db);
        float* gb = (float*)(p.ws + OFF_DEC) + (size_t)item * 128; gb[lane] = g; gb[64 + lane] = sigm(db); }
    __syncthreads();
    { const float g63 = gS[63];
#pragma unroll
      for (int i = 0; i < 16; ++i) { const int idx = tid + i * NTH, s = idx >> 7, d = idx & 127; KT[d * 72 + s] = (bf16_t)f2bf(Kf[s * 129 + d] * gS[128 + s] * __expf(g63 - gS[s])); } }
    bf16_t* tq = (bf16_t*)(p.ws + OFF_TQ);
    __syncthreads();
#pragma unroll
    for (int i = 0; i < 4; ++i) { const int tl = wv * 4 + i, kind = tl >> 4, ti = (tl >> 2) & 3, sj = tl & 3; const int t = ti * 16 + r, s0 = sj * 16 + 4 * q;
        f32x4 a = (f32x4){0.f, 0.f, 0.f, 0.f};
        if (sj <= ti) a = mma16<128>((kind ? Qd : Kd) + ti * 16 * 136, 136, Kd + sj * 16 * 136, 136, a, lane);
        const float gt = gS[t], bt = gS[64 + t]; float o[4];
#pragma unroll
        for (int j = 0; j < 4; ++j) { const int s = s0 + j; const float e = __expf(fminf(gt - gS[s], 0.f)); o[j] = kind ? (s <= t ? a[j] * e : 0.f) : (s < t ? bt * a[j] * e : 0.f); }
        if (kind) { u32x2 w; w.x = pk2(o[0], o[1]); w.y = pk2(o[2], o[3]); *(u32x2*)(tq + (size_t)(1088 + item) * 4096 + t * 64 + s0) = w; }
        else {
#pragma unroll
            for (int j = 0; j < 4; ++j) Af[t * 65 + s0 + j] = o[j]; } }
    __syncthreads();
    if (wv == 0) {
        for (int t = 0; t < 64; ++t) { float sum = (t == lane) ? 1.f : 0.f;
            for (int s = 0; s < t; ++s) sum -= Af[t * 65 + s] * Xs[s * 65 + lane];
            Xs[t * 65 + lane] = sum; }
    } else {
        bf16_t* ktb = (bf16_t*)(p.ws + OFF_ATT) + (size_t)item * 8192;
        for (int pc = tid - 64; pc < 3072; pc += NTH - 64) { const int w = pc >> 10, e = pc & 1023;
            if (w == 0) *(u32x4*)(z + (size_t)(e >> 4) * ZO + 1024 + h * 128 + (e & 15) * 8) = *(const LAS u32x4*)(Qd + (e >> 4) * 136 + (e & 15) * 8);
            else if (w == 1) *(u32x4*)(z + (size_t)(e >> 4) * ZO + 1536 + h * 128 + (e & 15) * 8) = *(const LAS u32x4*)(Kd + (e >> 4) * 136 + (e & 15) * 8);
            else *(u32x4*)(ktb + (e >> 3) * 64 + (e & 7) * 8) = *(const LAS u32x4*)(KT + (e >> 3) * 72 + (e & 7) * 8); }
    }
    __syncthreads();
    { const int t = tid >> 3, s0 = (tid & 7) * 8; unsigned w[4];
#pragma unroll
      for (int j = 0; j < 4; ++j) { const int s = s0 + 2 * j; w[j] = pk2(s <= t ? Xs[t * 65 + s] : 0.f, s + 1 <= t ? Xs[t * 65 + s + 1] : 0.f); }
      *(u32x4*)(tq + (size_t)item * 4096 + t * 64 + s0) = (u32x4){w[0], w[1], w[2], w[3]}; }
}
__device__ __forceinline__ float gelu_t(float x) { const float y = 0.7978845608028654f * (x + 0.044715f * x * x * x); return 0.5f * x * (2.0f - 2.0f / (1.0f + __expf(2.0f * y))); }
template <int MODE> __device__ void lru_item(const Params& p, int c, LAS unsigned char* lds) {
    LAS bf16_t* XH = (LAS bf16_t*)lds; LAS float* Au = (LAS float*)(XH + 64 * 520); LAS float* Uu = Au + 64 * 65; LAS bf16_t* Wa = (LAS bf16_t*)(Uu + 64 * 65); LAS bf16_t* Wx = Wa + 64 * 72;
    const int tid = ltid(), lane = tid & 63, wv = __builtin_amdgcn_readfirstlane(tid >> 6), r = lane & 15, q = lane >> 4;
    bf16_t* z = (bf16_t*)(p.ws + OFF_Z) + (size_t)c * 64 * ZO; const bf16_t* snap = (const bf16_t*)(p.ws + OFF_SNAP);
    const bool lastc = (c >= 256) || ((c & 63) == 63); const int seq = c >= 256 ? c - 256 : c >> 6;
    float* Ab = (float*)(p.ws + OFF_LRU); float* Hb = Ab + NCH * 512; const float* hin = Hb + NCH * 512;
    __syncthreads();
    { const int ch = tid; const float* cw = p.in[23]; const float w0 = cw[ch], w1 = cw[512 + ch], w2 = cw[1024 + ch], w3 = cw[1536 + ch], bias = p.in[24][ch];
      float x3 = 0.f, x2 = 0.f, x1 = 0.f;
      if (c >= 256) { const float* st = p.in[5] + (size_t)(c - 256) * 3 * 512 + ch; x3 = st[0]; x2 = st[512]; x1 = st[1024]; }
      else if (c & 63) { const bf16_t* sp = snap + (size_t)(c - 1) * 3 * ZO + ch; x3 = bf2f(sp[0]); x2 = bf2f(sp[ZO]); x1 = bf2f(sp[2 * ZO]); }
      float* lco = p.out + (c >= 256 ? O_LCS : O_LCP) + (size_t)seq * 3 * 512 + ch;
      for (int t0 = 0; t0 < 64; t0 += 8) { float xv[8];
#pragma unroll
          for (int j = 0; j < 8; ++j) xv[j] = bf2f(z[(size_t)(t0 + j) * ZO + ch]);
#pragma unroll
          for (int j = 0; j < 8; ++j) { const int t = t0 + j; const float x = xv[j]; const float y = w3 * x + w2 * x1 + w1 * x2 + w0 * x3 + bias; x3 = x2; x2 = x1; x1 = x;
              XH[t * 520 + ch] = (bf16_t)f2bf(y);
              if (MODE == 1 && lastc && t >= 61) lco[(size_t)(t - 61) * 512] = x; } } }
    const bf16_t* lw = (const bf16_t*)(p.ws + OFF_LRUW);
    for (int n = 0; n < 8; ++n) {
        { const int e = tid >> 3, d0 = (tid & 7) * 8; *(LAS u32x4*)(Wa + e * 72 + d0) = *(const u32x4*)(lw + (size_t)n * 4096 + e * 64 + d0); *(LAS u32x4*)(Wx + e * 72 + d0) = *(const u32x4*)(lw + (size_t)(8 + n) * 4096 + e * 64 + d0); }
        __syncthreads();
        { const int gate = wv >> 2;
#pragma unroll
          for (int i = 0; i < 4; ++i) { const int tile = (wv & 3) * 4 + i, ti = tile >> 2, ej = tile & 3;
              const f32x4 a = mma16<64>(XH + ti * 16 * 520 + n * 64, 520, (gate ? Wx : Wa) + ej * 16 * 72, 72, (f32x4){0.f, 0.f, 0.f, 0.f}, lane);
              const int t = ti * 16 + r;
#pragma unroll
              for (int j = 0; j < 4; ++j) { const int e = ej * 16 + 4 * q + j, ch = n * 64 + e;
                  if (gate == 0) Au[t * 65 + e] = -8.0f * sigm(a[j] + p.in[26][ch]) * softplus(-p.in[29][ch]);
                  else Uu[t * 65 + e] = sigm(a[j] + p.in[28][ch]) * bf2f(XH[t * 520 + ch]); } } }
        __syncthreads();
        if (wv == 0) { const int ch = n * 64 + lane; float hh = MODE ? hin[(size_t)c * 512 + ch] : 0.f, A = 1.f;
            for (int t = 0; t < 64; ++t) { const float la = Au[t * 65 + lane]; const float a = __expf(la); const float u = sqrtf(-expm1f(2.0f * la)) * Uu[t * 65 + lane]; hh = a * hh + u; A *= a; if (MODE) Uu[t * 65 + lane] = hh; }
            if (MODE == 0) { Ab[(size_t)c * 512 + ch] = A; Hb[(size_t)c * 512 + ch] = hh; }
            else if (lastc) p.out[(c >= 256 ? O_LHS : O_LHP) + (size_t)seq * 512 + ch] = hh; }
        __syncthreads();
        if (MODE) {
#pragma unroll
            for (int i = 0; i < 8; ++i) { const int idx = tid + i * NTH, t = idx >> 6, e = idx & 63; const float lg = bf2f(z[(size_t)t * ZO + 512 + n * 64 + e]);
                z[(size_t)t * ZO + n * 64 + e] = (bf16_t)f2bf(gelu_t(lg) * Uu[t * 65 + e]); } }
    }
}
__device__ void o2_run(const Params& p, int c0, int nch, int h, int sl, const float* s_in, float* s_out, LAS unsigned char* lds) {
    LAS bf16_t* Kd = (LAS bf16_t*)lds; LAS bf16_t* Qd = Kd + 64 * 136; LAS bf16_t* KT = Qd + 64 * 136; LAS bf16_t* Tm = KT + 128 * 72; LAS bf16_t* QKm = Tm + 64 * 72;
    LAS bf16_t* ST = QKm + 64 * 72; LAS bf16_t* RT = ST + 16 * 136; LAS bf16_t* WT = RT + 16 * 72; LAS bf16_t* Vs = WT + 16 * 72; LAS float* gg = (LAS float*)(Vs + 64 * 16);
    const int tid = ltid(), lane = tid & 63, wv = __builtin_amdgcn_readfirstlane(tid >> 6), r = lane & 15, q = lane >> 4;
    bf16_t* zb = (bf16_t*)(p.ws + OFF_Z); const bf16_t* ktb = (const bf16_t*)(p.ws + OFF_ATT); const bf16_t* tqb = (const bf16_t*)(p.ws + OFF_TQ); const float* gb = (const float*)(p.ws + OFF_DEC);
    const int qc = 1024 + h * 128, kc = 1536 + h * 128, vc = 2048 + h * 128 + sl * 16;
    f32x4 S = (f32x4){0.f, 0.f, 0.f, 0.f};
    if (s_in) {
#pragma unroll
        for (int j = 0; j < 4; ++j) S[j] = s_in[(size_t)(16 * wv + 4 * q + j) * 128 + sl * 16 + r]; }
    __syncthreads();
    { u32x2 w; w.x = pk2(S[0], S[1]); w.y = pk2(S[2], S[3]); *(LAS u32x2*)(ST + r * 136 + 16 * wv + 4 * q) = w; }
    u32x4 rk[2], rq[2], rkt[2], rT, rQ, rv; float rg = 0.f; rv = (u32x4){0u, 0u, 0u, 0u};
#define O2_LD(cc) do { const bf16_t* z_ = zb + (size_t)(cc) * 64 * ZO; const int it_ = (cc) * 4 + h; \
        _Pragma("unroll") for (int i_ = 0; i_ < 2; ++i_) { const int pc_ = tid + i_ * NTH; rk[i_] = *(const u32x4*)(z_ + (size_t)(pc_ >> 4) * ZO + kc + (pc_ & 15) * 8); rq[i_] = *(const u32x4*)(z_ + (size_t)(pc_ >> 4) * ZO + qc + (pc_ & 15) * 8); \
            rkt[i_] = *(const u32x4*)(ktb + (size_t)it_ * 8192 + pc_ * 8); } \
        rT = *(const u32x4*)(tqb + (size_t)it_ * 4096 + tid * 8); rQ = *(const u32x4*)(tqb + (size_t)(1088 + it_) * 4096 + tid * 8); \
        if (tid < 128) { rv = *(const u32x4*)(z_ + (size_t)(tid >> 1) * ZO + vc + (tid & 1) * 8); rg = gb[(size_t)it_ * 128 + tid]; } } while (0)
    O2_LD(c0);
    for (int n = 0; n < nch; ++n) {
        const int c = c0 + n;
#pragma unroll
        for (int i = 0; i < 2; ++i) { const int pc = tid + i * NTH; *(LAS u32x4*)(Kd + (pc >> 4) * 136 + (pc & 15) * 8) = rk[i]; *(LAS u32x4*)(Qd + (pc >> 4) * 136 + (pc & 15) * 8) = rq[i];
            *(LAS u32x4*)(KT + (pc >> 3) * 72 + (pc & 7) * 8) = rkt[i]; }
        *(LAS u32x4*)(Tm + (tid >> 3) * 72 + (tid & 7) * 8) = rT; *(LAS u32x4*)(QKm + (tid >> 3) * 72 + (tid & 7) * 8) = rQ;
        if (tid < 128) { *(LAS u32x4*)(Vs + (tid >> 1) * 16 + (tid & 1) * 8) = rv; gg[tid] = rg; }
        __syncthreads();
        if (n + 1 < nch) O2_LD(c + 1);
        f32x4 QS = (f32x4){0.f, 0.f, 0.f, 0.f};
        if (wv < 4) { const f32x4 ks = mma16<128>(Kd + wv * 16 * 136, 136, ST, 136, (f32x4){0.f, 0.f, 0.f, 0.f}, lane);
            const int s = 16 * wv + r; const float eg = __expf(gg[s]), bt = gg[64 + s]; const u32x2 vv = *(const LAS u32x2*)(Vs + s * 16 + 4 * q);
            const float v0 = bf2f(vv.x & 0xffff), v1 = bf2f(vv.x >> 16), v2 = bf2f(vv.y & 0xffff), v3 = bf2f(vv.y >> 16);
            RT[(4 * q + 0) * 72 + s] = (bf16_t)f2bf(bt * (v0 - eg * ks[0])); RT[(4 * q + 1) * 72 + s] = (bf16_t)f2bf(bt * (v1 - eg * ks[1]));
            RT[(4 * q + 2) * 72 + s] = (bf16_t)f2bf(bt * (v2 - eg * ks[2])); RT[(4 * q + 3) * 72 + s] = (bf16_t)f2bf(bt * (v3 - eg * ks[3])); }
        else QS = mma16<128>(Qd + (wv - 4) * 16 * 136, 136, ST, 136, QS, lane);
        __syncthreads();
        if (wv < 4) { const f32x4 w = mma16<64>(Tm + wv * 16 * 72, 72, RT, 72, (f32x4){0.f, 0.f, 0.f, 0.f}, lane); const int t = 16 * wv + r;
#pragma unroll
            for (int j = 0; j < 4; ++j) WT[(4 * q + j) * 72 + t] = (bf16_t)f2bf(w[j]); }
        __syncthreads();
        if (wv >= 4) { const int t = 16 * (wv - 4) + r; const float eg = __expf(gg[t]);
            const f32x4 o = mma16<64>(QKm + (wv - 4) * 16 * 72, 72, WT, 72, QS * eg, lane);
            u32x2 w; w.x = pk2(o[0], o[1]); w.y = pk2(o[2], o[3]); *(u32x2*)(zb + (size_t)(c * 64 + t) * ZO + vc + 4 * q) = w; }
        S = mma16<64>(WT, 72, KT + wv * 16 * 72, 72, S * __expf(gg[63]), lane);
        __syncthreads();
        { u32x2 w; w.x = pk2(S[0], S[1]); w.y = pk2(S[2], S[3]); *(LAS u32x2*)(ST + r * 136 + 16 * wv + 4 * q) = w; }
    }
#pragma unroll
    for (int j = 0; j < 4; ++j) s_out[(size_t)(16 * wv + 4 * q + j) * 128 + sl * 16 + r] = S[j];
}
__device__ void phase_o1(const Params& p, LAS unsigned char* lds) {
    for (int it = blockIdx.x; it < NCH * 5; it += gridDim.x) { if (it < NCH * 4) o1_delta(p, it >> 2, it & 3, lds); else lru_item<0>(p, it - NCH * 4, lds); }
}
__device__ void phase_o2(const Params& p, LAS unsigned char* lds) {
    const int G = gridDim.x, b = blockIdx.x, tid = ltid();
    float* Ab = (float*)(p.ws + OFF_LRU); float* Hb = Ab + NCH * 512; float* hin = Hb + NCH * 512;
    for (int gid = (G - 1 - b) * NTH + tid; gid < 2048 + 8192; gid += G * NTH) {
        if (gid < 2048) { const int seq = gid >> 9, ch = gid & 511; float hh = 0.f;
            for (int n0 = 0; n0 < 64; n0 += 8) { float a[8], u[8];
#pragma unroll
                for (int j = 0; j < 8; ++j) { a[j] = Ab[(size_t)(seq * 64 + n0 + j) * 512 + ch]; u[j] = Hb[(size_t)(seq * 64 + n0 + j) * 512 + ch]; }
#pragma unroll
                for (int j = 0; j < 8; ++j) { hin[(size_t)(seq * 64 + n0 + j) * 512 + ch] = hh; hh = a[j] * hh + u[j]; } } }
        else { const int k = gid - 2048; hin[(size_t)256 * 512 + k] = p.in[4][k]; }
    }
    for (int it = b; it < 128 + 512; it += G) {
        if (it < 128) { const int g = it & 15, sl = it >> 4, seq = g >> 2, h = g & 3;
            o2_run(p, seq * 64, 64, h, sl, nullptr, p.out + O_DNP + (size_t)(seq * 4 + h) * 16384, lds); }
        else { const int j = it - 128, g = j & 63, sl = j >> 6, seq = g >> 2, h = g & 3;
            o2_run(p, 256 + seq, 1, h, sl, p.in[6] + (size_t)(seq * 4 + h) * 16384, p.out + O_DNS + (size_t)(seq * 4 + h) * 16384, lds); }
    }
}
__device__ void phase_o3(const Params& p, LAS unsigned char* lds) {
    const int lane = ltid() & 63, wv = __builtin_amdgcn_readfirstlane(ltid() >> 6);
    for (int c = blockIdx.x; c < NCH; c += gridDim.x) {
        lru_item<1>(p, c, lds);
        __syncthreads();
        bf16_t* z = (bf16_t*)(p.ws + OFF_Z) + (size_t)c * 64 * ZO;
        for (int it0 = wv * 32; it0 < wv * 32 + 32; it0 += 4) { unsigned ov[4], gv[4];
#pragma unroll
            for (int u = 0; u < 4; ++u) { const int it = it0 + u, t = it >> 2, h = it & 3; ov[u] = *(const unsigned*)(z + (size_t)t * ZO + 2048 + h * 128 + 2 * lane); gv[u] = *(const unsigned*)(z + (size_t)t * ZO + 2560 + h * 128 + 2 * lane); }
#pragma unroll
            for (int u = 0; u < 4; ++u) { const int it = it0 + u, t = it >> 2, h = it & 3;
                const float o0 = bf2f(ov[u] & 0xffff), o1 = bf2f(ov[u] >> 16), g0 = bf2f(gv[u] & 0xffff), g1 = bf2f(gv[u] >> 16); float sq = o0 * o0 + o1 * o1;
#pragma unroll
                for (int o = 32; o >= 1; o >>= 1) sq += __shfl_xor(sq, o);
                const float rs = rsqrtf(sq * (1.0f / 128.0f) + EPS); const float* gn = p.in[33] + h * 128 + 2 * lane;
                *(unsigned*)(z + (size_t)t * ZO + 512 + h * 128 + 2 * lane) = pk2(o0 * rs * gn[0] * silu(g0), o1 * rs * gn[1] * silu(g1)); } }
    }
}
__device__ void phase_final(const Params& p) {
    const int lane = ltid() & 63, wv = __builtin_amdgcn_readfirstlane(ltid() >> 6); const float* ss = (const float*)(p.ws + OFF_SS) + (size_t)6 * MTOK;
    for (int row = blockIdx.x * 8 + wv; row < MTOK; row += gridDim.x * 8) { const float rs = rsqrtf(ss[row] * (1.0f / 1024.0f) + EPS);
#pragma unroll
        for (int i = 0; i < 4; ++i) { float* xp = p.out + (size_t)row * DM + i * 256 + lane * 4; const f32x4 g = *(const f32x4*)(p.in[15] + i * 256 + lane * 4); *(f32x4*)xp = *(const f32x4*)xp * rs * g; } }
}
__global__ void __launch_bounds__(NTH, 2) mega_fwd(Params p) {
    extern __shared__ __attribute__((aligned(16))) unsigned char shm[];
    LAS unsigned char* lds = (LAS unsigned char*)shm;
    cg::grid_group grid = cg::this_grid();
    unsigned char* ws = p.ws; float* xres = p.out; bf16_t* xb = (bf16_t*)(ws + OFF_XB); bf16_t* zz = (bf16_t*)(ws + OFF_Z); float* ss = (float*)(ws + OFF_SS);
#define IN(k) (p.lo <= (k) && (k) < p.hi)
#define SEAM(k) do { if (IN(k) && IN((k) + 1)) grid.sync(); } while (0)
#ifndef NO_PREP
    if (IN(0)) { phase_prep(p, lds); phase_weights(p, 0, lds); }
#endif
    SEAM(0);
#pragma unroll 1
    for (int l = 0; l < 2; ++l) {
        const int pb = 1 + 10 * l; const int ldz = l ? ZO : ZE;
#if !defined(NO_GEMM) && (!defined(GEMM_ONLY) || GEMM_ONLY == 0)
        if (IN(pb + 0)) run_gemm(lds, xb, DM, (const bf16_t*)(ws + W_F1IN), 2 * FF, DM, EpiSwiGLU{zz, ss + (size_t)(3 * l) * MTOK});
#endif
        SEAM(pb + 0);
#if !defined(NO_GEMM) && (!defined(GEMM_ONLY) || GEMM_ONLY == 1)
        if (IN(pb + 1)) run_gemm(lds, zz, FF, (const bf16_t*)(ws + W_F1OUT), DM, FF, EpiResid{xres, xb, ss + (size_t)(3 * l + 1) * MTOK, 0.5f});
#endif
        SEAM(pb + 1);
#if !defined(NO_GEMM) && (!defined(GEMM_ONLY) || GEMM_ONLY == 2)
        if (IN(pb + 2)) run_gemm(lds, xb, DM, (const bf16_t*)(ws + W_MIN), ldz, DM, EpiZ{zz, ldz, ss + (size_t)(3 * l + 1) * MTOK, l ? (bf16_t*)(ws + OFF_SNAP) : nullptr});
#endif
        SEAM(pb + 2);
#ifndef NO_MIXX
        if (IN(pb + 3)) {
#ifndef NO_E1
 if (l == 0) phase_e1(p, lds);
#endif
#ifndef NO_O1
 if (l == 1) phase_o1(p, lds);
#endif
 }
#endif
        SEAM(pb + 3);
#ifndef NO_MIXX
        if (IN(pb + 4)) {
#ifndef NO_E2
 if (l == 0) phase_e2(p, lds);
#endif
#ifndef NO_O2
 if (l == 1) phase_o2(p, lds);
#endif
 }
#endif
        SEAM(pb + 4);
#ifndef NO_MIXX
        if (IN(pb + 5)) {
#ifndef NO_E3
 if (l == 0) phase_e3(p);
#endif
#ifndef NO_O3
 if (l == 1) phase_o3(p, lds);
#endif
 }
#endif
        SEAM(pb + 5);
#if !defined(NO_GEMM) && (!defined(GEMM_ONLY) || GEMM_ONLY == 3)
        if (IN(pb + 6)) run_gemm(lds, zz, ldz, (const bf16_t*)(ws + W_MOUT), DM, DM, EpiResid{xres, xb, ss + (size_t)(3 * l + 2) * MTOK, 1.0f});
#endif
        SEAM(pb + 6);
#if !defined(NO_GEMM) && (!defined(GEMM_ONLY) || GEMM_ONLY == 4)
        if (IN(pb + 7)) run_gemm(lds, xb, DM, (const bf16_t*)(ws + W_F2IN), 2 * FF, DM, EpiSwiGLU{zz, ss + (size_t)(3 * l + 2) * MTOK});
#endif
        SEAM(pb + 7);
#if !defined(NO_GEMM) && (!defined(GEMM_ONLY) || GEMM_ONLY == 5)
        if (IN(pb + 8)) run_gemm(lds, zz, FF, (const bf16_t*)(ws + W_F2OUT), DM, FF, EpiResid{xres, xb, ss + (size_t)(3 * l + 3) * MTOK, 0.5f});
#endif
        SEAM(pb + 8);
#ifndef NO_PREP
        if (IN(pb + 9)) { if (l == 0) phase_weights(p, 1, lds); else phase_final(p); }
#endif
        if (l == 0) SEAM(pb + 9);
    }
}

#ifndef N_LAUNCH_MODE
#define N_LAUNCH_MODE 1
#endif
extern "C" void kernel_launch(void* const* d_in, const int* in_sizes, int n_in, void* d_out, int out_size, void* d_ws, size_t ws_size, hipStream_t stream) {
    static int grid = 0;
    if (grid == 0) {
        if (n_in != 34 || ws_size < WS_END || out_size != 21891072) { fprintf(stderr, "kernel_launch: unexpected problem: n_in %d ws %zu (need %zu) out %d\n", n_in, ws_size, (size_t)WS_END, out_size); grid = -1; return; }
        int dev = 0, cus = 0, per_cu = 0;
        hipGetDevice(&dev); hipDeviceGetAttribute(&cus, hipDeviceAttributeMultiprocessorCount, dev);
        if (hipFuncSetAttribute((const void*)mega_fwd, hipFuncAttributeMaxDynamicSharedMemorySize, LDS_BYTES) != hipSuccess) { fprintf(stderr, "kernel_launch: hipFuncSetAttribute failed\n"); grid = -1; return; }
        if (hipOccupancyMaxActiveBlocksPerMultiprocessor(&per_cu, (const void*)mega_fwd, NTH, LDS_BYTES) != hipSuccess || per_cu < 1) { fprintf(stderr, "kernel_launch: occupancy query gives %d\n", per_cu); per_cu = 1; }
        (void)hipGetLastError();
        grid = cus;
        fprintf(stderr, "kernel_launch: grid %d (per_cu %d), ws need %zu have %zu\n", grid, per_cu, (size_t)WS_END, ws_size);
    }
    if (grid < 0) return;
    Params p{};
    for (int i = 0; i < 34; ++i) p.in[i] = (const float*)d_in[i];
    p.out = (float*)d_out; p.ws = (unsigned char*)d_ws;
#if N_LAUNCH_MODE == 1
    p.lo = 0; p.hi = 21;
    void* args[] = {&p};
    hipError_t e = hipLaunchCooperativeKernel((const void*)mega_fwd, dim3(grid), dim3(NTH), args, LDS_BYTES, stream);
    if (e != hipSuccess) fprintf(stderr, "cooperative launch failed: %s (grid %d)\n", hipGetErrorString(e), grid);
#else
    for (int k = 0; k < 21; ++k) { p.lo = k; p.hi = k + 1; hipLaunchKernelGGL(mega_fwd, dim3(grid), dim3(NTH), LDS_BYTES, stream, p); }
#endif
}
```
